# Optimizing an MI355X kernel written in HIP

```python
import jax, jax.numpy as jnp
from jax import lax
import numpy as np

D_MODEL = 1024
BATCH = 32
SEQ = 2048
DEPTH = 4

GM_WIDTH = D_MODEL
GM_GROUPS = 8
GM_CHUNK = 128
LRU_WIDTH = D_MODEL
LRU_HEADS = 8
LRU_CONV = 4
LRU_C = 8.0
HG_HEADS = 8
HG_EXPAND = D_MODEL // HG_HEADS
HG_HEAD_DIM = D_MODEL // HG_HEADS
HG_KEY_WIDTH = HG_HEADS * HG_EXPAND
HG_WIDTH = HG_HEADS * HG_HEAD_DIM
HG_CHUNK = 32
N_BRANCH = 3
EPS = 1e-6
SPLIT_SIZES = (GM_WIDTH, GM_WIDTH, GM_WIDTH,
               LRU_WIDTH, LRU_WIDTH,
               HG_KEY_WIDTH, HG_KEY_WIDTH, HG_WIDTH, HG_WIDTH,
               N_BRANCH * D_MODEL)
IN_COLS = sum(SPLIT_SIZES)
SPLIT_POINTS = [int(s) for s in np.cumsum(SPLIT_SIZES)[:-1]]

kernel_name = "hybrid_gmlp_rglru_hgrn2_gated_merge"


def rms_norm(x, g):
    xf = x.astype(jnp.float32)
    y = xf * lax.rsqrt(jnp.mean(xf * xf, axis=-1, keepdims=True) + EPS)
    return (y * g.astype(jnp.float32)).astype(x.dtype)


def layer_norm(x, g, b):
    xf = x.astype(jnp.float32)
    mu = jnp.mean(xf, axis=-1, keepdims=True)
    xc = xf - mu
    y = xc * lax.rsqrt(jnp.mean(xc * xc, axis=-1, keepdims=True) + EPS)
    return (y * g.astype(jnp.float32) + b.astype(jnp.float32)).astype(x.dtype)


def chunked_spatial_gating(u, v, ln_g, ln_b, w_s, b_s):
    bsz, seq, width = v.shape
    v = layer_norm(v, ln_g, ln_b)
    vc = v.reshape(bsz, seq // GM_CHUNK, GM_CHUNK, GM_GROUPS, width // GM_GROUPS)
    causal = jnp.tril(jnp.ones((GM_CHUNK, GM_CHUNK), dtype=bool))
    w = jnp.where(causal[None], w_s, jnp.zeros_like(w_s))
    mixed = jnp.einsum('gts,bnsgc->bntgc', w, vc) + b_s.T[None, None, :, :, None]
    return u * mixed.reshape(bsz, seq, width)


def causal_depthwise_conv(x, w, b):
    k, width = w.shape
    out = lax.conv_general_dilated(
        x, w[:, None, :], window_strides=(1,), padding=[(k - 1, 0)],
        dimension_numbers=('NWC', 'WIO', 'NWC'), feature_group_count=width)
    return out + b


def block_diag_linear(x, w, b):
    bsz, seq, width = x.shape
    nh = w.shape[0]
    xh = x.reshape(bsz, seq, nh, width // nh)
    return jnp.einsum('bshi,hij->bshj', xh, w).reshape(bsz, seq, width) + b


def rg_lru(x, w_r, b_r, w_i, b_i, lam):
    f32 = jnp.float32
    r = jax.nn.sigmoid(block_diag_linear(x, w_r, b_r).astype(f32))
    i = jax.nn.sigmoid(block_diag_linear(x, w_i, b_i).astype(f32))
    log_a = -LRU_C * r * jax.nn.softplus(-lam.astype(f32))
    a = jnp.exp(log_a)
    mult = jnp.sqrt(-jnp.expm1(2.0 * log_a))
    bx = mult * (i * x.astype(f32))

    def step(h, ab):
        a_t, b_t = ab
        h = a_t * h + b_t
        return h, h

    h0 = jnp.zeros((x.shape[0], x.shape[2]), f32)
    _, hs = lax.scan(step, h0, (jnp.swapaxes(a, 0, 1), jnp.swapaxes(bx, 0, 1)))
    return jnp.swapaxes(hs, 0, 1).astype(x.dtype)


def hgrn2_chunked(q, f_raw, v, lower_bound):
    f32 = jnp.float32
    bsz, seq, nh, dk = q.shape
    dv = v.shape[-1]
    nc = seq // HG_CHUNK
    lb = lower_bound.reshape(nh, dk).astype(f32)
    fr = f_raw.astype(f32)
    f = lb + (1.0 - lb) * jax.nn.sigmoid(fr)
    k = (1.0 - lb) * jax.nn.sigmoid(-fr)
    g = jnp.log(f)

    def to_chunks(t):
        return jnp.moveaxis(t.reshape(bsz, nc, HG_CHUNK, nh, t.shape[-1]), 1, 0)

    gcum = jnp.cumsum(to_chunks(g), axis=2)
    causal = jnp.tril(jnp.ones((HG_CHUNK, HG_CHUNK), dtype=bool))[None, :, :, None, None]

    def step(state, inp):
        qc, kc, vc, gc = inp
        o_inter = jnp.einsum('bthk,bhkv->bthv', qc * jnp.exp(gc), state)
        diff = gc[:, :, None] - gc[:, None, :]
        decay = jnp.exp(jnp.where(causal, diff, -jnp.inf))
        scores = jnp.einsum('bthk,bshk,btshk->bhts', qc, kc, decay)
        o_intra = jnp.einsum('bhts,bshv->bthv', scores, vc)
        g_last = gc[:, -1]
        k_dec = kc * jnp.exp(g_last[:, None] - gc)
        state = state * jnp.exp(g_last)[..., None] + jnp.einsum('bshk,bshv->bhkv', k_dec, vc)
        return state, o_inter + o_intra

    s0 = jnp.zeros((bsz, nh, dk, dv), f32)
    _, out = lax.scan(step, s0, (to_chunks(q.astype(f32)), to_chunks(k),
                                 to_chunks(v.astype(f32)), gcum))
    return jnp.moveaxis(out, 0, 1).reshape(bsz, seq, nh, dv)


def hybrid_layer(x, pre_g, post_g, w_in, b_merge,
                 gm_ln_g, gm_ln_b, gm_w_s, gm_b_s,
                 lru_conv_w, lru_conv_b, lru_w_r, lru_b_r, lru_w_i, lru_b_i, lru_lambda,
                 hg_lb, hg_norm_g, w_a_proj, w_b_proj, w_c_proj, w_out):
    bsz, seq, _ = x.shape
    xn = rms_norm(x, pre_g)
    z = jnp.einsum('bsd,dn->bsn', xn, w_in)
    (gm_u, gm_v, gm_gate, lru_x, lru_gate,
     hg_q, hg_f, hg_i, hg_gate, merge) = jnp.split(z, SPLIT_POINTS, axis=-1)

    y_a = chunked_spatial_gating(jax.nn.gelu(gm_u), jax.nn.gelu(gm_v),
                                 gm_ln_g, gm_ln_b, gm_w_s, gm_b_s)
    y_a = jnp.einsum('bsw,wd->bsd', y_a * jax.nn.silu(gm_gate), w_a_proj)

    xb = causal_depthwise_conv(lru_x, lru_conv_w, lru_conv_b)
    y_b = rg_lru(xb, lru_w_r, lru_b_r, lru_w_i, lru_b_i, lru_lambda)
    y_b = jnp.einsum('bsw,wd->bsd', y_b * jax.nn.silu(lru_gate), w_b_proj)

    o = hgrn2_chunked(hg_q.reshape(bsz, seq, HG_HEADS, HG_EXPAND),
                      hg_f.reshape(bsz, seq, HG_HEADS, HG_EXPAND),
                      hg_i.reshape(bsz, seq, HG_HEADS, HG_HEAD_DIM), hg_lb)
    o = o * lax.rsqrt(jnp.mean(o * o, axis=-1, keepdims=True) + EPS)
    o = (o * hg_norm_g.astype(jnp.float32).reshape(HG_HEADS, HG_HEAD_DIM))
    o = o.reshape(bsz, seq, HG_WIDTH).astype(x.dtype)
    y_c = jnp.einsum('bsw,wd->bsd', o * jax.nn.silu(hg_gate), w_c_proj)

    gates = jax.nn.sigmoid(merge.reshape(bsz, seq, N_BRANCH, D_MODEL) + b_merge)
    merged = gates[:, :, 0] * y_a + gates[:, :, 1] * y_b + gates[:, :, 2] * y_c
    y = jnp.einsum('bsd,de->bse', merged, w_out)
    return x + rms_norm(y, post_g)


def setup_inputs(seed: int = 0) -> dict:
    key = jax.random.key(seed)
    ks = jax.random.split(key, 22)
    f32 = jnp.float32
    L, D = DEPTH, D_MODEL
    nrm = lambda k, shape, s: jax.random.normal(k, shape, f32) * s
    dh_lru = LRU_WIDTH // LRU_HEADS
    u = jax.random.uniform(ks[15], (L, LRU_WIDTH), f32, 0.9, 0.999)
    a_base = u ** (1.0 / LRU_C)
    return {
        "x": nrm(ks[0], (BATCH, SEQ, D), 1.0),
        "pre_norm_g": 1.0 + nrm(ks[1], (L, D), 0.02),
        "post_norm_g": 1.0 + nrm(ks[2], (L, D), 0.02),
        "w_in": nrm(ks[3], (L, D, IN_COLS), D ** -0.5),
        "b_merge": nrm(ks[4], (L, N_BRANCH, D), 0.02),
        "gm_ln_g": 1.0 + nrm(ks[5], (L, GM_WIDTH), 0.02),
        "gm_ln_b": nrm(ks[6], (L, GM_WIDTH), 0.02),
        "gm_w_s": nrm(ks[7], (L, GM_GROUPS, GM_CHUNK, GM_CHUNK), GM_CHUNK ** -0.5),
        "gm_b_s": 1.0 + nrm(ks[8], (L, GM_GROUPS, GM_CHUNK), 0.02),
        "lru_conv_w": nrm(ks[9], (L, LRU_CONV, LRU_WIDTH), LRU_CONV ** -0.5),
        "lru_conv_b": nrm(ks[10], (L, LRU_WIDTH), 0.02),
        "lru_w_r": nrm(ks[11], (L, LRU_HEADS, dh_lru, dh_lru), dh_lru ** -0.5),
        "lru_b_r": nrm(ks[12], (L, LRU_WIDTH), 0.02),
        "lru_w_i": nrm(ks[13], (L, LRU_HEADS, dh_lru, dh_lru), dh_lru ** -0.5),
        "lru_b_i": nrm(ks[14], (L, LRU_WIDTH), 0.02),
        "lru_lambda": jnp.log(a_base) - jnp.log1p(-a_base),
        "hg_lower_bounds": nrm(ks[16], (L, HG_KEY_WIDTH), 0.1),
        "hg_norm_g": 1.0 + nrm(ks[17], (L, HG_WIDTH), 0.02),
        "w_a_proj": nrm(ks[18], (L, GM_WIDTH, D), GM_WIDTH ** -0.5),
        "w_b_proj": nrm(ks[19], (L, LRU_WIDTH, D), LRU_WIDTH ** -0.5),
        "w_c_proj": nrm(ks[20], (L, HG_WIDTH, D), HG_WIDTH ** -0.5),
        "w_out": nrm(ks[21], (L, D, D), D ** -0.5),
    }


def reference(x, pre_norm_g, post_norm_g, w_in, b_merge, gm_ln_g, gm_ln_b, gm_w_s, gm_b_s,
              lru_conv_w, lru_conv_b, lru_w_r, lru_b_r, lru_w_i, lru_b_i, lru_lambda,
              hg_lower_bounds, hg_norm_g, w_a_proj, w_b_proj, w_c_proj, w_out):
    p = jax.nn.softmax(hg_lower_bounds.astype(jnp.float32), axis=0)
    lower_bounds = jnp.cumsum(p, axis=0) - p[0]
    h = x
    for l in range(DEPTH):
        h = hybrid_layer(h, pre_norm_g[l], post_norm_g[l], w_in[l], b_merge[l],
                         gm_ln_g[l], gm_ln_b[l], gm_w_s[l], gm_b_s[l],
                         lru_conv_w[l], lru_conv_b[l], lru_w_r[l], lru_b_r[l],
                         lru_w_i[l], lru_b_i[l], lru_lambda[l],
                         lower_bounds[l], hg_norm_g[l],
                         w_a_proj[l], w_b_proj[l], w_c_proj[l], w_out[l])
    return h
```

```cpp
#include <hip/hip_runtime.h>
#include <cstdio>
#include <cstdint>
#define MK_SINGLE 0
namespace pg8 {
#define PG8_LAS __attribute__((address_space(3)))
typedef unsigned short bf16_t;
typedef short bf16x8 __attribute__((ext_vector_type(8)));
typedef float f32x4 __attribute__((ext_vector_type(4)));
typedef unsigned u32x4 __attribute__((ext_vector_type(4)));
constexpr int BM = 256, BK = 64, HALF = 128, HTB = HALF * BK * 2  , STAGE_BYTES = 8 * HTB, NXCD = 8, WGM = 8;

__host__ __device__ __forceinline__ int lds_byte(int r, int c) { const int st = (r >> 4) * 2 + (c >> 5), rr = r & 15, cc = c & 31, ob = rr * 64 + cc * 2; return st * 1024 + (ob ^ (((ob >> 9) & 1) << 5)); }
__host__ __device__ __forceinline__ void stage_rc(int b, int& R, int& C) { const int st = b / 1024, sb = b % 1024, swz = sb ^ (((sb >> 9) & 1) << 5); R = (st >> 1) * 16 + swz / 64; C = (st & 1) * 32 + (swz % 64) / 2; }
__host__ __device__ __forceinline__ int perm32(int rho) { const int n = rho >> 4, i = rho & 15; return 8 * (i >> 2) + 4 * n + (i & 3); }

struct Unit { int pm, pn; };
struct Gemm { const bf16_t* A; const bf16_t* Bt; int M, N, K; };

struct StaticOrder {
    int nM, nN, nwg, G, c;
    __host__ __device__ void init(int M, int N, int G_, int c_) { nM = M / BM; nN = N / BM; nwg = nM * nN; G = G_; c = c_; }
    __host__ __device__ bool next(int i, Unit& u) const {
        const long L = (long)i * G + c; if (L >= nwg) return false;
        int wgid = (int)L; { const int q = nwg / NXCD, r = nwg % NXCD, xcd = wgid % NXCD, off = wgid / NXCD; wgid = (xcd < r ? xcd * (q + 1) : r * (q + 1) + (xcd - r) * q) + off; }
        const int nig = WGM * nN, gid = wgid / nig, fm = gid * WGM, gsz = (nM - fm) < WGM ? (nM - fm) : WGM;
        u.pm = fm + ((wgid % nig) % gsz); u.pn = (wgid % nig) / gsz; return true;
    }
    __device__ __forceinline__ void a_ready(const Unit&) const {}
    __device__ __forceinline__ void done(const Unit&) const {}
};
__device__ __forceinline__ unsigned cvt_pk_bf16(float lo, float hi) { unsigned r; asm volatile("v_cvt_pk_bf16_f32 %0, %1, %2" : "=v"(r) : "v"(lo), "v"(hi)); return r; }
typedef float f32x2 __attribute__((ext_vector_type(2)));
typedef __bf16 bf16x2v __attribute__((ext_vector_type(2)));
__device__ __forceinline__ unsigned cvt2(float lo, float hi) { const f32x2 v = {lo, hi}; const bf16x2v b = __builtin_convertvector(v, bf16x2v); return __builtin_bit_cast(unsigned, b); }
__device__ __forceinline__ float sigm_f(float x) { return __builtin_amdgcn_rcpf(1.0f + __builtin_amdgcn_exp2f(-1.44269504089f * x)); }

struct EpiZ {
    static constexpr bool PERM = true, AFTER_DRAIN = false;
    bf16_t* O; int ldc;
    __device__ __forceinline__ void operator()(const f32x4 (&acc)[2][2][4][2], const Unit& u, int wr, int wc, int fr, int fq) const {
        const int row0 = u.pm * BM + wr * 64 + fr, col0 = u.pn * BM + wc * 32 + 8 * fq;
#pragma unroll
        for (int ai = 0; ai < 2; ++ai)
#pragma unroll
            for (int m = 0; m < 4; ++m) { bf16_t* rowp = O + (size_t)(row0 + ai * HALF + m * 16) * ldc + col0;
#pragma unroll
                for (int bj = 0; bj < 2; ++bj) { const f32x4 v0 = acc[ai][bj][m][0], v1 = acc[ai][bj][m][1];
                    u32x4 w; w.x = cvt2(v0[0], v0[1]); w.y = cvt2(v0[2], v0[3]); w.z = cvt2(v1[0], v1[1]); w.w = cvt2(v1[2], v1[3]);
                    *(u32x4*)(rowp + bj * HALF) = w; } }
    }
};
struct EpiY {
    static constexpr bool PERM = true, AFTER_DRAIN = false;
    float* O; int ldc;
    __device__ __forceinline__ void operator()(const f32x4 (&acc)[2][2][4][2], const Unit& u, int wr, int wc, int fr, int fq) const {
        const int row0 = u.pm * BM + wr * 64 + fr, col0 = u.pn * BM + wc * 32 + 8 * fq;
#pragma unroll
        for (int ai = 0; ai < 2; ++ai)
#pragma unroll
            for (int m = 0; m < 4; ++m) { float* rowp = O + (size_t)(row0 + ai * HALF + m * 16) * ldc + col0;
#pragma unroll
                for (int bj = 0; bj < 2; ++bj) { *(f32x4*)(rowp + bj * HALF) = acc[ai][bj][m][0]; *(f32x4*)(rowp + bj * HALF + 4) = acc[ai][bj][m][1]; } }
    }
};
struct ProjOrder {
    StaticOrder so;
    __device__ bool next(int i, Unit& u) const { const int tile = i / 3, br = i - 3 * tile; Unit b; if (!so.next(tile, b)) return false; u.pm = br * 64 + b.pm; u.pn = br * 4 + b.pn; return true; }
    __device__ __forceinline__ void a_ready(const Unit&) const {}
    __device__ __forceinline__ void done(const Unit&) const {}
};
struct EpiMerge {
    static constexpr bool PERM = true, AFTER_DRAIN = false;
    const bf16_t* Zm;
    const float* bm;
    float* part;
    bf16_t* merged;
    __device__ __forceinline__ void operator()(const f32x4 (&acc)[2][2][4][2], const Unit& u, int wr, int wc, int fr, int fq) const {
        const int br = u.pn >> 2, pm = u.pm - 64 * br, pn = u.pn & 3;
        const int row0 = pm * BM + wr * 64 + fr, col0 = pn * BM + wc * 32 + 8 * fq;
        f32x4 bv[2][2];
#pragma unroll
        for (int bj = 0; bj < 2; ++bj)
#pragma unroll
            for (int n = 0; n < 2; ++n) bv[bj][n] = *(const f32x4*)(bm + br * 1024 + col0 + bj * HALF + 4 * n);
#pragma unroll
        for (int ai = 0; ai < 2; ++ai)
#pragma unroll
            for (int m = 0; m < 4; ++m) { const int row = row0 + ai * HALF + m * 16;
#pragma unroll
                for (int bj = 0; bj < 2; ++bj) { const int col = col0 + bj * HALF;
                    const u32x4 zg = *(const u32x4*)(Zm + (size_t)row * 12288 + br * 1024 + col);
                    f32x4 g0, g1;
                    g0[0] = __uint_as_float(zg.x << 16); g0[1] = __uint_as_float(zg.x & 0xffff0000u); g0[2] = __uint_as_float(zg.y << 16); g0[3] = __uint_as_float(zg.y & 0xffff0000u);
                    g1[0] = __uint_as_float(zg.z << 16); g1[1] = __uint_as_float(zg.z & 0xffff0000u); g1[2] = __uint_as_float(zg.w << 16); g1[3] = __uint_as_float(zg.w & 0xffff0000u);
                    g0 = g0 + bv[bj][0]; g1 = g1 + bv[bj][1];
                    f32x4 v0, v1;
#pragma unroll
                    for (int e = 0; e < 4; ++e) { v0[e] = sigm_f(g0[e]) * acc[ai][bj][m][0][e]; v1[e] = sigm_f(g1[e]) * acc[ai][bj][m][1][e]; }
                    float* pp = part + (size_t)row * 1024 + col;
                    if (br > 0) { v0 = v0 + *(const f32x4*)pp; v1 = v1 + *(const f32x4*)(pp + 4); }
                    if (br < 2) { *(f32x4*)pp = v0; *(f32x4*)(pp + 4) = v1; }
                    else { u32x4 w; w.x = cvt2(v0[0], v0[1]); w.y = cvt2(v0[2], v0[3]); w.z = cvt2(v1[0], v1[1]); w.w = cvt2(v1[2], v1[3]);
                        *(u32x4*)(merged + (size_t)row * 1024 + col) = w; } } }
    }
};
template <class Epi, class Sched, bool ALIGN_EPI = false, bool SP2 = false>
__device__ __forceinline__ void gemm_phase(PG8_LAS unsigned char* lds, const Gemm g, const Sched& S, const Epi& E) {
    int tid_ = threadIdx.x; asm volatile("" : "+v"(tid_));
    const int tid = tid_, wid = __builtin_amdgcn_readfirstlane(tid >> 6), lane = tid & 63, wr = wid >> 2, wc = wid & 3, fr = lane & 15, fq = lane >> 4;
    const int K = g.K, nt = K / BK;
    unsigned voffA[2], voffB[2];
#pragma unroll
    for (int i = 0; i < 2; ++i) { int R, C; stage_rc(tid * 16 + i * 8192, R, C); const int Rb = Epi::PERM ? ((R & ~31) + perm32(R & 31)) : R;
        voffA[i] = (unsigned)(R * K + C) * 2u; voffB[i] = (unsigned)(Rb * K + C) * 2u; }
    const size_t kstep = (size_t)(BK * 2);
    const size_t hstep = (size_t)HALF * K * 2;
    const size_t tstep = 2 * hstep;
    const unsigned ldsw = (unsigned)wid * 1024u;
    const int aoff = lds_byte(wr * 64 + fr, fq * 8), boff = lds_byte(wc * 32 + fr, fq * 8);
#define PG8_SA(b, h) (((b) * 2 + (h)) * HTB)
#define PG8_SB(b, h) ((4 + (b) * 2 + (h)) * HTB)
#define PG8_STAGE(bufoff, gbase, voff) do { _Pragma("unroll") for (int _i = 0; _i < 2; ++_i) \
        __builtin_amdgcn_global_load_lds((const unsigned*)((const char*)(gbase) + (voff)[_i]), (PG8_LAS unsigned*)(lds + (bufoff) + ldsw + _i * 8192), 16, 0, 0); } while (0)
#define PG8_LDA(dst, b, h) do { _Pragma("unroll") for (int m = 0; m < 4; ++m) _Pragma("unroll") for (int k = 0; k < 2; ++k) dst[m][k] = *(const PG8_LAS bf16x8*)(lds + PG8_SA(b, h) + aoff + m * 2048 + k * 1024); } while (0)
#define PG8_LDB(dst, b, h) do { _Pragma("unroll") for (int n = 0; n < 2; ++n) _Pragma("unroll") for (int k = 0; k < 2; ++k) dst[n][k] = *(const PG8_LAS bf16x8*)(lds + PG8_SB(b, h) + boff + n * 2048 + k * 1024); } while (0)
#define PG8_MMA(ai, bj, At, Bt) do { __builtin_amdgcn_s_setprio(1); _Pragma("unroll") for (int m = 0; m < 4; ++m) _Pragma("unroll") for (int n = 0; n < 2; ++n) _Pragma("unroll") for (int k = 0; k < 2; ++k) \
        acc[ai][bj][m][n] = __builtin_amdgcn_mfma_f32_16x16x32_bf16(Bt[n][k], At[m][k], acc[ai][bj][m][n], 0, 0, 0); __builtin_amdgcn_s_setprio(0); } while (0)
#define PG8_WAIT_V(n) asm volatile("s_waitcnt vmcnt(" #n ")" ::: "memory")
#define PG8_WAIT_L(n) asm volatile("s_waitcnt lgkmcnt(" #n ")" ::: "memory")
#define PG8_BAR __builtin_amdgcn_s_barrier()
#define PG8_SCHED __builtin_amdgcn_sched_barrier(0)
    Unit cur, nxt; int ui = 0;
    if (!S.next(0, cur)) return;
    f32x4 acc[2][2][4][2];
#pragma unroll
    for (int a = 0; a < 2; ++a)
#pragma unroll
        for (int b = 0; b < 2; ++b)
#pragma unroll
            for (int m = 0; m < 4; ++m)
#pragma unroll
                for (int n = 0; n < 2; ++n) acc[a][b][m][n] = (f32x4){0.f, 0.f, 0.f, 0.f};
    bf16x8 At[4][2], B0[2][2], B1[2][2];
    const char* cA = (const char*)g.A + (size_t)cur.pm * tstep; const char* cB = (const char*)g.Bt + (size_t)cur.pn * tstep;
    S.a_ready(cur);
    if constexpr (SP2) {
        PG8_STAGE(PG8_SB(0, 0), cB, voffB); PG8_STAGE(PG8_SB(0, 1), cB + hstep, voffB); PG8_STAGE(PG8_SA(0, 0), cA, voffA); PG8_STAGE(PG8_SA(0, 1), cA + hstep, voffA);
        if (wr == 1) PG8_BAR;
        PG8_WAIT_V(2); PG8_BAR;
        PG8_STAGE(PG8_SB(1, 0), cB + kstep, voffB); PG8_STAGE(PG8_SA(1, 0), cA + kstep, voffA); PG8_STAGE(PG8_SB(1, 1), cB + hstep + kstep, voffB);
        PG8_WAIT_V(6); PG8_BAR;
    } else {
        PG8_STAGE(PG8_SB(0, 0), cB, voffB); PG8_STAGE(PG8_SA(0, 0), cA, voffA); PG8_STAGE(PG8_SB(0, 1), cB + hstep, voffB); PG8_STAGE(PG8_SA(0, 1), cA + hstep, voffA);
        if (wr == 1) PG8_BAR;
        PG8_WAIT_V(4); PG8_BAR;
        PG8_STAGE(PG8_SB(1, 0), cB + kstep, voffB); PG8_STAGE(PG8_SA(1, 0), cA + kstep, voffA); PG8_STAGE(PG8_SB(1, 1), cB + hstep + kstep, voffB);
        PG8_WAIT_V(6); PG8_BAR;
    }
    for (;;) {
        const bool has_next = S.next(ui + 1, nxt);
        const char* nA = has_next ? (const char*)g.A + (size_t)nxt.pm * tstep : cA; const char* nB = has_next ? (const char*)g.Bt + (size_t)nxt.pn * tstep : cB;
        for (int t = 0; t < nt; t += 2) {
            const bool last = (t == nt - 2);
            const char* a1 = cA + (size_t)(t + 1) * kstep;
            const char* a2 = last ? nA : cA + (size_t)(t + 2) * kstep; const char* b2 = last ? nB : cB + (size_t)(t + 2) * kstep;
            const char* a3 = a2 + kstep; const char* b3 = b2 + kstep;
            if (last && has_next) S.a_ready(nxt);
            if constexpr (SP2) {
            PG8_LDB(B0, 0, 0); PG8_LDB(B1, 0, 1); PG8_SCHED; PG8_LDA(At, 0, 0); PG8_STAGE(PG8_SA(1, 1), a1 + hstep, voffA);
            PG8_WAIT_V(8); PG8_WAIT_L(0); PG8_BAR; PG8_MMA(0, 0, At, B0); PG8_MMA(0, 1, At, B1); PG8_BAR; PG8_SCHED;
            PG8_LDA(At, 0, 1); PG8_STAGE(PG8_SB(0, 0), b2, voffB); PG8_STAGE(PG8_SB(0, 1), b2 + hstep, voffB); PG8_STAGE(PG8_SA(0, 0), a2, voffA);
            PG8_WAIT_V(8); PG8_WAIT_L(0); PG8_BAR; PG8_MMA(1, 0, At, B0); PG8_MMA(1, 1, At, B1); PG8_BAR; PG8_SCHED;
            PG8_LDB(B0, 1, 0); PG8_LDB(B1, 1, 1); PG8_SCHED; PG8_LDA(At, 1, 0); PG8_STAGE(PG8_SA(0, 1), a2 + hstep, voffA);
            PG8_WAIT_V(8); PG8_WAIT_L(0); PG8_BAR; PG8_MMA(0, 0, At, B0); PG8_MMA(0, 1, At, B1); PG8_BAR; PG8_SCHED;
            PG8_LDA(At, 1, 1); PG8_STAGE(PG8_SB(1, 0), b3, voffB); PG8_STAGE(PG8_SB(1, 1), b3 + hstep, voffB); PG8_STAGE(PG8_SA(1, 0), a3, voffA);
            PG8_WAIT_V(8); PG8_WAIT_L(0); PG8_BAR; PG8_MMA(1, 0, At, B0); PG8_MMA(1, 1, At, B1); PG8_BAR; PG8_SCHED;
            } else {
            PG8_LDB(B0, 0, 0); PG8_SCHED; PG8_LDA(At, 0, 0); PG8_STAGE(PG8_SA(1, 1), a1 + hstep, voffA);
            PG8_WAIT_L(8); PG8_BAR; PG8_WAIT_L(0); PG8_MMA(0, 0, At, B0); PG8_BAR; PG8_SCHED;
            PG8_LDB(B1, 0, 1); PG8_STAGE(PG8_SB(0, 0), b2, voffB);
            PG8_BAR; PG8_WAIT_L(0); PG8_MMA(0, 1, At, B1); PG8_BAR;
            PG8_LDA(At, 0, 1); PG8_STAGE(PG8_SA(0, 0), a2, voffA);
            PG8_BAR; PG8_WAIT_L(0); PG8_MMA(1, 0, At, B0); PG8_BAR; PG8_SCHED;
            PG8_STAGE(PG8_SB(0, 1), b2 + hstep, voffB);
            PG8_WAIT_V(6); PG8_BAR; PG8_MMA(1, 1, At, B1); PG8_BAR;
            PG8_LDB(B0, 1, 0); PG8_SCHED; PG8_LDA(At, 1, 0); PG8_STAGE(PG8_SA(0, 1), a2 + hstep, voffA);
            PG8_WAIT_L(8); PG8_BAR; PG8_WAIT_L(0); PG8_MMA(0, 0, At, B0); PG8_BAR; PG8_SCHED;
            PG8_LDB(B1, 1, 1); PG8_STAGE(PG8_SB(1, 0), b3, voffB);
            PG8_BAR; PG8_WAIT_L(0); PG8_MMA(0, 1, At, B1); PG8_BAR;
            PG8_LDA(At, 1, 1); PG8_STAGE(PG8_SA(1, 0), a3, voffA);
            PG8_BAR; PG8_WAIT_L(0); PG8_MMA(1, 0, At, B0); PG8_BAR; PG8_SCHED;
            PG8_STAGE(PG8_SB(1, 1), b3 + hstep, voffB);
            PG8_WAIT_V(6); PG8_BAR; PG8_MMA(1, 1, At, B1); PG8_BAR;
            }
        }
        if constexpr (ALIGN_EPI) { if (wr == 0) PG8_BAR; }
        if constexpr (!Epi::AFTER_DRAIN) { E(acc, cur, wr, wc, fr, fq); S.done(cur); }
        if (!has_next) break;
#pragma unroll
        for (int a = 0; a < 2; ++a)
#pragma unroll
            for (int b = 0; b < 2; ++b)
#pragma unroll
                for (int m = 0; m < 4; ++m)
#pragma unroll
                    for (int n = 0; n < 2; ++n) acc[a][b][m][n] = (f32x4){0.f, 0.f, 0.f, 0.f};
        cur = nxt; cA = nA; cB = nB; ++ui;
        if constexpr (ALIGN_EPI) { if (wr == 1) PG8_BAR; }
    }
    PG8_WAIT_V(0);
    if constexpr (!ALIGN_EPI) { if (wr == 0) PG8_BAR; }
    PG8_BAR;
    if constexpr (Epi::AFTER_DRAIN) { E.fused(acc, cur, wr, wc, fr, fq, lds, wid, lane); S.done(cur); }
#undef PG8_SA
#undef PG8_SB
#undef PG8_STAGE
#undef PG8_LDA
#undef PG8_LDB
#undef PG8_MMA
#undef PG8_WAIT_V
#undef PG8_WAIT_L
#undef PG8_BAR
#undef PG8_SCHED
}
}
#define LAS __attribute__((address_space(3)))
#define XB_TMO      128
#define XB_XCNT(j)  (256  + 64 * (j))
#define XB_XSUB(j)  (1280 + 64 * (j))
#define XB_XGEN(j)  (2304 + 64 * (j))
#define XB_TOP      3328
#define XB_TOPGEN   3392
#define XCD_BAR_WORDS 3456
#define XB_SPIN_CAP (1u << 18)

__device__ __forceinline__ unsigned xb_ld(unsigned* p)              { return __hip_atomic_load(p, __ATOMIC_RELAXED, __HIP_MEMORY_SCOPE_AGENT); }
__device__ __forceinline__ unsigned xb_add(unsigned* p, unsigned v) { return __hip_atomic_fetch_add(p, v, __ATOMIC_RELAXED, __HIP_MEMORY_SCOPE_AGENT); }
__device__ __forceinline__ unsigned xb_xcc_id() { return (unsigned)__builtin_amdgcn_s_getreg((3 << 11) | 20) & 0xFu; }
#define XB_SPIN(cond, bar) do { unsigned _sp = 0; while (cond) { __builtin_amdgcn_s_sleep(1); \
    if ((++_sp & 255u) == 0u) { if (xb_ld(&(bar)[XB_TMO])) break; if (_sp > XB_SPIN_CAP) { atomicAdd(&(bar)[XB_TMO], 1u); break; } } } } while (0)

struct XcdBarrier {
    unsigned* bar; unsigned x;
    volatile LAS unsigned* st;
};

__device__ __forceinline__ XcdBarrier xcd_barrier_post(unsigned* bar, volatile LAS unsigned* st) {
    XcdBarrier b; b.bar = bar; b.x = xb_xcc_id(); b.st = st;
    if (threadIdx.x == 0) (void)xb_add(&bar[XB_XCNT(b.x)], 1u);
    return b;
}
__device__ __forceinline__ void xcd_barrier_complete(unsigned* bar, unsigned x, unsigned& nloc, unsigned& nx) {
    const unsigned G = gridDim.x * gridDim.y * gridDim.z;
    unsigned sum, cnt, mine, sp = 0u;
    for (;;) {
        sum = 0u; cnt = 0u; mine = 0u;
#pragma unroll
        for (unsigned j = 0; j < 16; ++j) { const unsigned c = xb_ld(&bar[XB_XCNT(j)]); sum += c; cnt += (c > 0u) ? 1u : 0u; mine = (j == x) ? c : mine; }
        if (sum == G) break;
        __builtin_amdgcn_s_sleep(1);
        if ((++sp & 255u) == 0u) { if (xb_ld(&bar[XB_TMO])) break; if (sp > XB_SPIN_CAP) { atomicAdd(&bar[XB_TMO], 1u); break; } }
    }
    nloc = mine > 0u ? mine : 1u; nx = cnt > 0u ? cnt : 1u;
}

__device__ __forceinline__ void xcd_barrier(const XcdBarrier& b) {
    asm volatile("s_waitcnt vmcnt(0)" ::: "memory");
    __syncthreads();
    if (threadIdx.x == 0) {
        unsigned* bar = b.bar;
        __builtin_amdgcn_s_waitcnt(0);
        unsigned nloc = b.st[0], nx = b.st[1];
        if (nloc == 0u) { xcd_barrier_complete(bar, b.x, nloc, nx); b.st[0] = nloc; b.st[1] = nx; }
        const unsigned old = xb_add(&bar[XB_XSUB(b.x)], 1u);
        const unsigned gen = old / nloc;
        if (old + 1u == (gen + 1u) * nloc) {
            __builtin_amdgcn_fence(__ATOMIC_RELEASE, "agent");
            asm volatile("s_waitcnt vmcnt(0)" ::: "memory");
            const unsigned og = xb_add(&bar[XB_TOP], 1u);
            const unsigned tg = og / nx;
            if (og + 1u == (tg + 1u) * nx) xb_add(&bar[XB_TOPGEN], 1u);
            else XB_SPIN(xb_ld(&bar[XB_TOPGEN]) == tg, bar);
            __builtin_amdgcn_fence(__ATOMIC_ACQUIRE, "agent");
            xb_add(&bar[XB_XGEN(b.x)], 1u);
            asm volatile("s_waitcnt vmcnt(0)" ::: "memory");
        } else {
            XB_SPIN(xb_ld(&bar[XB_XGEN(b.x)]) == gen, bar);
            __builtin_amdgcn_fence(__ATOMIC_ACQUIRE, "agent");
            asm volatile("s_waitcnt vmcnt(0)" ::: "memory");
        }
    }
    __syncthreads();
}
constexpr int NWAVES = 8;
constexpr int DM = 1024, BATCH = 32, SEQ = 2048, DEPTH = 4, NCOL = 12288;
constexpr int GB = 8, NGRP = BATCH / GB, MG = GB * SEQ;
constexpr float EPSN = 1e-6f;
constexpr int C_U = 0, C_V = 1024, C_GA = 2048, C_LX = 3072, C_LG = 4096, C_HQ = 5120, C_HF = 6144, C_HI = 7168, C_HG = 8192, C_MG = 9216;

constexpr size_t MiB = 1u << 20;
constexpr size_t WS_CTL = 0, CTL_ZERO_BYTES = 1 * MiB;
constexpr size_t WS_WIN = 1 * MiB;
constexpr size_t WS_WPJ = WS_WIN + 96 * MiB;
constexpr size_t WS_WRI = WS_WPJ + 32 * MiB;
constexpr size_t WS_WSM = WS_WRI + 2 * MiB;
constexpr size_t WS_SML = WS_WSM + 1 * MiB;
constexpr size_t WS_XN = WS_SML + 1 * MiB;
constexpr size_t WS_Z = WS_XN + 32 * MiB;
constexpr size_t WS_YA = WS_Z + 384 * MiB;
constexpr size_t WS_PART = WS_YA + 96 * MiB;
constexpr size_t WS_MRG = WS_PART + 64 * MiB;
constexpr size_t WS_Y = WS_MRG + 32 * MiB;
constexpr size_t WS_END = WS_Y + 64 * MiB;
constexpr int CW_BAR = 4096;

constexpr int RING_BYTES = 131072;
constexpr int LDSCTL_OFF = RING_BYTES, MISC_OFF = LDSCTL_OFF + 320;
constexpr int LDS_BYTES = 147456;

#define GAS __attribute__((address_space(1)))
#define DI __device__ __forceinline__
typedef unsigned short bf16;
typedef unsigned v4u __attribute__((ext_vector_type(4)));
typedef unsigned v2u __attribute__((ext_vector_type(2)));
typedef float f32x4 __attribute__((ext_vector_type(4)));
typedef short bf16x8 __attribute__((ext_vector_type(8)));
typedef short bf16x4 __attribute__((ext_vector_type(4)));
typedef GAS unsigned gu32;
#define RLX_AGENT __ATOMIC_RELAXED, __HIP_MEMORY_SCOPE_AGENT
#define LDS_WAIT() asm volatile("s_waitcnt lgkmcnt(0)" ::: "memory")
#define VM_WAIT() asm volatile("s_waitcnt vmcnt(0)" ::: "memory")
DI unsigned f2bf(float f) { unsigned u = __builtin_bit_cast(unsigned, f); return (u + 0x7fffu + ((u >> 16) & 1u)) >> 16; }
DI unsigned pk2(float lo, float hi) { return f2bf(lo) | (f2bf(hi) << 16); }
DI unsigned cvtpk(float lo, float hi) { return pg8::cvt2(lo, hi); }

DI float ex2f(float x) { return __builtin_amdgcn_exp2f(x); }
DI float fexp(float x) { return __builtin_amdgcn_exp2f(x * 1.44269504089f); }
DI float flog(float x) { return __builtin_amdgcn_logf(x) * 0.69314718056f; }
DI float frcp(float x) { return __builtin_amdgcn_rcpf(x); }
DI float frsq(float x) { return __builtin_amdgcn_rsqf(x); }
DI float sigm(float x) { return frcp(1.0f + ex2f(-1.44269504089f * x)); }
DI float silu(float x) { return x * sigm(x); }
DI float gelu_t(float x) { return x * sigm(1.5957691216f * (x + 0.044715f * x * x * x)); }
DI void unpack8(const v4u r, float (&f)[8]) {
    f[0] = __uint_as_float(r.x << 16); f[1] = __uint_as_float(r.x & 0xffff0000u); f[2] = __uint_as_float(r.y << 16); f[3] = __uint_as_float(r.y & 0xffff0000u);
    f[4] = __uint_as_float(r.z << 16); f[5] = __uint_as_float(r.z & 0xffff0000u); f[6] = __uint_as_float(r.w << 16); f[7] = __uint_as_float(r.w & 0xffff0000u);
}
DI v4u pack8(const float (&f)[8]) { v4u o; o.x = cvtpk(f[0], f[1]); o.y = cvtpk(f[2], f[3]); o.z = cvtpk(f[4], f[5]); o.w = cvtpk(f[6], f[7]); return o; }
DI float wave_sum(float v) {
#pragma unroll
    for (int o = 1; o < 64; o <<= 1) v += __shfl_xor(v, o);
    return v;
}
DI f32x4 mfma16(bf16x8 a, bf16x8 b, f32x4 c) { return __builtin_amdgcn_mfma_f32_16x16x32_bf16(a, b, c, 0, 0, 0); }
DI bf16x4 tr16(const LAS unsigned char* p) { return __builtin_bit_cast(bf16x4, __builtin_amdgcn_ds_read_tr16_b64_v4i16((LAS bf16x4*)p)); }
DI bf16x8 cat4(bf16x4 a, bf16x4 b) { return __builtin_shufflevector(a, b, 0, 1, 2, 3, 4, 5, 6, 7); }
DI bf16x8 pack_acc(f32x4 a, f32x4 b) { v4u o; o.x = cvtpk(a[0], a[1]); o.y = cvtpk(a[2], a[3]); o.z = cvtpk(b[0], b[1]); o.w = cvtpk(b[2], b[3]); return __builtin_bit_cast(bf16x8, o); }

struct Frame {
    LAS unsigned char* lds;
    volatile LAS unsigned* MISC;
    gu32* ctl;
    int tid, lane, wave;
    int vcu, G;
};
enum { P_X = 0, P_PRE_G, P_POST_G, P_W_IN, P_B_MERGE, P_LN_G, P_LN_B, P_W_S, P_B_S, P_CONV_W, P_CONV_B, P_W_R, P_B_R, P_W_I, P_B_I, P_LAM, P_HG_LB, P_HG_NG, P_W_A, P_W_B, P_W_C, P_W_O, P_OUT, P_WS, P_N };
DI unsigned long long ptab(const Frame& F, int k) {
    const volatile LAS unsigned* t = (const volatile LAS unsigned*)(F.lds + LDSCTL_OFF) + 2 * k;
    const unsigned lo = __builtin_amdgcn_readfirstlane(t[0]), hi = __builtin_amdgcn_readfirstlane(t[1]);
    return ((unsigned long long)hi << 32) | lo;
}
DI const float* pin(const Frame& F, int k) { return (const float*)ptab(F, k); }
DI float* pout(const Frame& F) { return (float*)ptab(F, P_OUT); }
DI unsigned char* pws(const Frame& F) { return (unsigned char*)ptab(F, P_WS); }
template <class T> DI T* wsp(const Frame& F, size_t off) { return (T*)(pws(F) + off); }
DI Frame phase_frame(const Frame& F0) { Frame F = F0; int t = F0.tid; asm volatile("" : "+v"(t)); F.tid = t; F.lane = t & 63; F.wave = __builtin_amdgcn_readfirstlane(t >> 6); return F; }

DI void p0_transpose_item(const float* W, int K, int N, bf16* WT, LAS float* scr, int item, int lane) {
    const int nblk = N / 32, kb = item / nblk, nb = item % nblk, k0 = 64 * kb, n0 = 32 * nb;
#pragma unroll 8
    for (int i = 0; i < 32; ++i) { const int kk = 2 * i + (lane >> 5); scr[kk * 33 + (lane & 31)] = W[(size_t)(k0 + kk) * N + n0 + (lane & 31)]; }
    LDS_WAIT(); asm volatile("" ::: "memory");
    const int c = lane & 7;
#pragma unroll
    for (int j = 0; j < 4; ++j) { const int n = (lane >> 3) + 8 * j; const LAS float* s = scr + (8 * c) * 33 + n;
        v4u o; o.x = pk2(s[0 * 33], s[1 * 33]); o.y = pk2(s[2 * 33], s[3 * 33]); o.z = pk2(s[4 * 33], s[5 * 33]); o.w = pk2(s[6 * 33], s[7 * 33]);
        *(GAS v4u*)(WT + (size_t)(n0 + n) * K + k0 + 8 * c) = o; }
    LDS_WAIT(); asm volatile("" ::: "memory");
}
DI void p0_prologue(const Frame& F0) {
    const Frame F = phase_frame(F0);
    LAS float* scr = (LAS float*)(F.lds + F.wave * 16384);
    const int gw = F.vcu * NWAVES + F.wave, NGW = F.G * NWAVES;
    constexpr int I_IN = (DM / 64) * (NCOL / 32);
    constexpr int I_PJ = (DM / 64) * (DM / 32);
    constexpr int I_RI = (128 / 64) * (128 / 32);
    constexpr int N_IN = DEPTH * I_IN, N_PJ = DEPTH * 4 * I_PJ, N_RI = DEPTH * 2 * 8 * I_RI;
    for (int it = gw; it < N_IN + N_PJ + N_RI; it += NGW) {
        int r = it;
        if (r < N_IN) { const int l = r / I_IN; p0_transpose_item(pin(F, P_W_IN) + (size_t)l * DM * NCOL, DM, NCOL, wsp<bf16>(F, WS_WIN) + (size_t)l * NCOL * DM, scr, r % I_IN, F.lane); continue; }
        r -= N_IN;
        if (r < N_PJ) { const int l = r / (4 * I_PJ), wsel = (r / I_PJ) & 3; const float* src = wsel == 0 ? pin(F, P_W_A) : wsel == 1 ? pin(F, P_W_B) : wsel == 2 ? pin(F, P_W_C) : pin(F, P_W_O);
            p0_transpose_item(src + (size_t)l * DM * DM, DM, DM, wsp<bf16>(F, WS_WPJ) + (size_t)(l * 4 + wsel) * DM * DM, scr, r % I_PJ, F.lane); continue; }
        r -= N_PJ;
        { const int mi = r / I_RI;
          const int l = mi >> 4, which = (mi >> 3) & 1, h = mi & 7; const float* src = (which ? pin(F, P_W_I) : pin(F, P_W_R)) + (size_t)(l * 8 + h) * 16384;
          p0_transpose_item(src, 128, 128, wsp<bf16>(F, WS_WRI) + (size_t)mi * 16384, scr, r % I_RI, F.lane); }
    }
    const int gt = gw * 64 + F.lane, NGT = NGW * 64;
    for (int i = gt; i < DEPTH * 8 * 128 * 128; i += NGT) { const int s = i & 127, t = (i >> 7) & 127; wsp<bf16>(F, WS_WSM)[i] = (bf16)f2bf(s <= t ? pin(F, P_W_S)[i] : 0.f); }
    for (int i = gt; i < 1024; i += NGT) {
        const float a0 = pin(F, P_HG_LB)[i], a1 = pin(F, P_HG_LB)[1024 + i], a2 = pin(F, P_HG_LB)[2048 + i], a3 = pin(F, P_HG_LB)[3072 + i];
        const float mx = fmaxf(fmaxf(a0, a1), fmaxf(a2, a3));
        const float e0 = expf(a0 - mx), e1 = expf(a1 - mx), e2 = expf(a2 - mx), e3 = expf(a3 - mx), inv = 1.0f / (e0 + e1 + e2 + e3);
        wsp<float>(F, WS_SML)[i] = 0.f; wsp<float>(F, WS_SML)[1024 + i] = e1 * inv; wsp<float>(F, WS_SML)[2048 + i] = (e1 + e2) * inv; wsp<float>(F, WS_SML)[3072 + i] = (e1 + e2 + e3) * inv;
    }
    for (int i = gt; i < DEPTH * 1024; i += NGT) { const float lm = pin(F, P_LAM)[i]; const float sp = (lm > 15.f) ? expf(-lm) : log1pf(expf(-lm)); (wsp<float>(F, WS_SML) + DEPTH * 1024)[i] = 8.0f * sp; }
}

DI void norm_phase(const Frame& F0, int l, int grp) {
    const Frame F = phase_frame(F0);
    const int gw = F.vcu * NWAVES + F.wave, NGW = F.G * NWAVES;
    const float* base = (l <= 1) ? pin(F, P_X) : pout(F);
    for (int m = gw; m < MG; m += NGW) {
        const size_t grow = (size_t)grp * MG + m;
        const GAS f32x4* xr = (const GAS f32x4*)(base + grow * DM) + F.lane;
        f32x4 v[4];
#pragma unroll
        for (int j = 0; j < 4; ++j) v[j] = xr[64 * j];
        if (l > 0) {
            const GAS f32x4* yr = (const GAS f32x4*)(wsp<float>(F, WS_Y) + (size_t)m * DM) + F.lane;
            const GAS f32x4* gr = (const GAS f32x4*)(pin(F, P_POST_G) + (size_t)(l - 1) * DM) + F.lane;
            f32x4 y[4]; float s = 0.f;
#pragma unroll
            for (int j = 0; j < 4; ++j) { y[j] = yr[64 * j]; s += (y[j].x * y[j].x + y[j].y * y[j].y) + (y[j].z * y[j].z + y[j].w * y[j].w); }
            const float rstd = 1.0f / sqrtf(wave_sum(s) * (1.f / DM) + EPSN);
            GAS f32x4* orow = (GAS f32x4*)(pout(F) + grow * DM) + F.lane;
#pragma unroll
            for (int j = 0; j < 4; ++j) { v[j] = v[j] + y[j] * rstd * gr[64 * j]; orow[64 * j] = v[j]; }
        }
        if (l < DEPTH) {
            float s2 = 0.f;
#pragma unroll
            for (int j = 0; j < 4; ++j) s2 += (v[j].x * v[j].x + v[j].y * v[j].y) + (v[j].z * v[j].z + v[j].w * v[j].w);
            const float rstd = 1.0f / sqrtf(wave_sum(s2) * (1.f / DM) + EPSN);
            const GAS f32x4* gr = (const GAS f32x4*)(pin(F, P_PRE_G) + (size_t)l * DM) + F.lane;
            GAS unsigned long long* o8 = (GAS unsigned long long*)(wsp<bf16>(F, WS_XN) + (size_t)m * DM) + F.lane;
#pragma unroll
            for (int j = 0; j < 4; ++j) { const f32x4 g = gr[64 * j]; const f32x4 t = v[j] * rstd * g;
                o8[64 * j] = (unsigned long long)cvtpk(t.x, t.y) | ((unsigned long long)cvtpk(t.z, t.w) << 32); }
        }
    }
}

namespace hg {
constexpr int SQ = 272, ST = 288;
constexpr int IMG_Q = 0, IMG_K = IMG_Q + 32 * SQ, IMG_KD = IMG_K + 32 * SQ, IMG_V = IMG_KD + 32 * ST, EGO = IMG_V + 32 * ST, IMGSZ = EGO + 512;
constexpr int OBUF = 2 * IMGSZ, OBW = 32 * 80, PART = OBUF + 8 * OBW, TABS = PART + 2 * 1024, LDS_END = TABS + 1024;
static_assert(LDS_END <= RING_BYTES && (IMGSZ % 16) == 0 && (OBUF % 16) == 0 && (TABS % 16) == 0, "hgrn lds map");
}
struct HgLoad { v4u q, f, v, g; };
DI void mix_hgrn(const Frame& F0, int l, int bl, int h) {
    const Frame F = phase_frame(F0);
    using namespace hg;
    LAS unsigned char* L = F.lds;
    const int w = F.wave, ln = F.lane, row = ln & 31, ch = ln >> 5, q = ln >> 4, c16 = ln & 15, ta = c16 >> 2, tp = c16 & 3;
    const int colp = 16 * w + 8 * ch;
    if (F.tid < 256) { const int k = F.tid & 127; ((LAS float*)(L + TABS))[F.tid] = (F.tid < 128) ? wsp<float>(F, WS_SML)[l * 1024 + h * 128 + k] : pin(F, P_HG_NG)[l * 1024 + h * 128 + k]; }
    const size_t tok0 = (size_t)bl * SEQ;
    const bf16* zq = wsp<bf16>(F, WS_Z) + (tok0 + row) * NCOL + C_HQ + h * 128 + colp;
    bf16* yo = wsp<bf16>(F, WS_YA) + (size_t)2 * MG * DM + (tok0 + row) * DM + h * 128 + colp;
    f32x4 S[8];
#pragma unroll
    for (int i = 0; i < 8; ++i) S[i] = (f32x4){0.f, 0.f, 0.f, 0.f};
    constexpr int NCH = SEQ / 32;
#define HG_LD(R, c) do { const bf16* p_ = zq + (size_t)(c) * 32 * NCOL; (R).q = *(const v4u*)p_; (R).f = *(const v4u*)(p_ + 1024); (R).v = *(const v4u*)(p_ + 2048); (R).g = *(const v4u*)(p_ + 3072); } while (0)
    auto prep = [&](const HgLoad& R, int par) {
        LAS unsigned char* I = L + par * IMGSZ;
        float fr[8], kk[8], gc[8];
        unpack8(R.f, fr);
        { const f32x4 l0 = *(const LAS f32x4*)(L + TABS + colp * 4), l1 = *(const LAS f32x4*)(L + TABS + colp * 4 + 16);
#pragma unroll
          for (int e = 0; e < 8; ++e) { const float lbe = e < 4 ? l0[e & 3] : l1[e & 3]; const float sg = sigm(fr[e]); const float f = lbe + (1.0f - lbe) * sg; kk[e] = 1.0f - f; gc[e] = fmaxf(flog(f), -30.f); } }
#pragma unroll
        for (int d = 1; d < 32; d <<= 1) {
#pragma unroll
            for (int e = 0; e < 8; ++e) { const float t = __shfl_up(gc[e], d, 32); if (row >= d) gc[e] += t; }
        }
        float qv[8], t8[8], eg[8];
        unpack8(R.q, qv);
#pragma unroll
        for (int e = 0; e < 8; ++e) t8[e] = qv[e] * fexp(fmaxf(gc[e], -80.f));
        *(LAS v4u*)(I + IMG_Q + row * SQ + colp * 2) = pack8(t8);
#pragma unroll
        for (int e = 0; e < 8; ++e) t8[e] = kk[e] * fexp(-fmaxf(gc[e], -80.f));
        *(LAS v4u*)(I + IMG_K + row * SQ + colp * 2) = pack8(t8);
#pragma unroll
        for (int e = 0; e < 8; ++e) { const float glast = __shfl(gc[e], 31, 32); t8[e] = kk[e] * fexp(glast - gc[e]); eg[e] = fexp(glast); }
        *(LAS v4u*)(I + IMG_KD + row * ST + colp * 2) = pack8(t8);
        *(LAS v4u*)(I + IMG_V + row * ST + colp * 2) = R.v;
        if (row == 31) { *(LAS f32x4*)(I + EGO + colp * 4) = (f32x4){eg[0], eg[1], eg[2], eg[3]}; *(LAS f32x4*)(I + EGO + colp * 4 + 16) = (f32x4){eg[4], eg[5], eg[6], eg[7]}; }
    };
    HgLoad R1, R2;
    HG_LD(R1, 0); HG_LD(R2, 1);
    __syncthreads();
    prep(R1, 0);
    v4u gate_cur = R1.g, gate_nxt = R2.g;
    R1 = R2;
    __syncthreads();
    for (int c = 0; c < NCH; ++c) {
        const int par = c & 1;
        if (c + 2 < NCH) HG_LD(R2, c + 2);
        const LAS unsigned char* I = L + par * IMGSZ;
        f32x4 X00 = {0.f, 0.f, 0.f, 0.f}, X01 = X00, X11 = X00, o0 = X00, o1 = X00;
#pragma unroll
        for (int kb = 0; kb < 4; ++kb) {
            const LAS unsigned char* pq = I + IMG_Q + c16 * SQ + (32 * kb + 4 * q) * 2;
            const LAS unsigned char* pk = I + IMG_K + c16 * SQ + (32 * kb + 4 * q) * 2;
            const bf16x8 Q0 = cat4(*(const LAS bf16x4*)pq, *(const LAS bf16x4*)(pq + 32)), Q1 = cat4(*(const LAS bf16x4*)(pq + 16 * SQ), *(const LAS bf16x4*)(pq + 16 * SQ + 32));
            const bf16x8 K0 = cat4(*(const LAS bf16x4*)pk, *(const LAS bf16x4*)(pk + 32)), K1 = cat4(*(const LAS bf16x4*)(pk + 16 * SQ), *(const LAS bf16x4*)(pk + 16 * SQ + 32));
            const bf16x8 SB = pack_acc(S[2 * kb], S[2 * kb + 1]);
            X00 = mfma16(K0, Q0, X00); X01 = mfma16(K0, Q1, X01); X11 = mfma16(K1, Q1, X11);
            o0 = mfma16(Q0, SB, o0); o1 = mfma16(Q1, SB, o1);
        }
#pragma unroll
        for (int i = 0; i < 4; ++i) { const bool keep = (4 * q + i) <= c16; X00[i] = keep ? X00[i] : 0.f; X11[i] = keep ? X11[i] : 0.f; }
        const bf16x8 VF = cat4(tr16(I + IMG_V + (4 * q + ta) * ST + (16 * w + 4 * tp) * 2), tr16(I + IMG_V + (16 + 4 * q + ta) * ST + (16 * w + 4 * tp) * 2));
        o0 = mfma16(pack_acc(X00, (f32x4){0.f, 0.f, 0.f, 0.f}), VF, o0); o1 = mfma16(pack_acc(X01, X11), VF, o1);
#pragma unroll
        for (int kt = 0; kt < 8; ++kt) {
            const bf16x8 KD = cat4(tr16(I + IMG_KD + (4 * q + ta) * ST + (16 * kt + 4 * tp) * 2), tr16(I + IMG_KD + (16 + 4 * q + ta) * ST + (16 * kt + 4 * tp) * 2));
            const f32x4 eg = *(const LAS f32x4*)(I + EGO + (16 * kt + 4 * q) * 4);
            S[kt] = mfma16(KD, VF, S[kt] * eg);
        }
        LAS unsigned char* OB = L + OBUF + w * OBW;
#pragma unroll
        for (int i = 0; i < 4; ++i) { *(LAS float*)(OB + (4 * q + i) * 80 + c16 * 4) = o0[i]; *(LAS float*)(OB + (16 + 4 * q + i) * 80 + c16 * 4) = o1[i]; }
        asm volatile("s_waitcnt lgkmcnt(0)" ::: "memory");
        {
            const f32x4 oa = *(const LAS f32x4*)(OB + row * 80 + ch * 32), ob = *(const LAS f32x4*)(OB + row * 80 + ch * 32 + 16);
            float ss = (oa[0] * oa[0] + oa[1] * oa[1]) + (oa[2] * oa[2] + oa[3] * oa[3]) + (ob[0] * ob[0] + ob[1] * ob[1]) + (ob[2] * ob[2] + ob[3] * ob[3]);
            ss += __shfl_xor(ss, 32);
            if (ln < 32) *(LAS float*)(L + PART + par * 1024 + row * 32 + w * 4) = ss;
        }
        if (c + 1 < NCH) { prep(R1, par ^ 1); gate_nxt = R1.g; }
        __syncthreads();
        {
            const f32x4 p0 = *(const LAS f32x4*)(L + PART + par * 1024 + row * 32), p1 = *(const LAS f32x4*)(L + PART + par * 1024 + row * 32 + 16);
            const float tot = (p0[0] + p0[1]) + (p0[2] + p0[3]) + (p1[0] + p1[1]) + (p1[2] + p1[3]);
            const float rstd = frsq(tot * (1.0f / 128.0f) + EPSN);
            const f32x4 oa = *(const LAS f32x4*)(OB + row * 80 + ch * 32), ob = *(const LAS f32x4*)(OB + row * 80 + ch * 32 + 16);
            const f32x4 n0 = *(const LAS f32x4*)(L + TABS + 512 + colp * 4), n1 = *(const LAS f32x4*)(L + TABS + 512 + colp * 4 + 16);
            float gt[8], ov[8];
            unpack8(gate_cur, gt);
#pragma unroll
            for (int e = 0; e < 4; ++e) { ov[e] = oa[e] * rstd * n0[e] * silu(gt[e]); ov[4 + e] = ob[e] * rstd * n1[e] * silu(gt[4 + e]); }
            *(v4u*)(yo + (size_t)c * 32 * DM) = pack8(ov);
        }
        gate_cur = gate_nxt; R1 = R2;
    }
#undef HG_LD
    __syncthreads();
}

namespace lr {
constexpr int SX = 272;
constexpr int XRAW = 0, IMG_XB = 9728, HBUF = IMG_XB + 2 * 32 * SX, HBW = 32 * 80, CWO = HBUF + 8 * HBW, LDS_END = CWO + 5 * 128 * 4;
static_assert(LDS_END <= RING_BYTES && (HBUF % 16) == 0 && (CWO % 16) == 0, "lru lds map");
}
struct LrLoad { v4u x, g; };
DI void mix_lru(const Frame& F0, int l, int bl, int h) {
    const Frame F = phase_frame(F0);
    using namespace lr;
    LAS unsigned char* L = F.lds;
    const int w = F.wave, ln = F.lane, row = ln & 31, ch = ln >> 5, q = ln >> 4, c16 = ln & 15;
    const int colp = 16 * w + 8 * ch;
    for (int i = F.tid; i < 640; i += NWAVES * 64) { const int j = i >> 7, cc = i & 127; ((LAS float*)(L + CWO))[i] = (j < 4) ? pin(F, P_CONV_W)[(size_t)(l * 4 + j) * 1024 + h * 128 + cc] : pin(F, P_CONV_B)[(size_t)l * 1024 + h * 128 + cc]; }
    if (row < 3) *(LAS v4u*)(L + XRAW + row * SX + colp * 2) = (v4u){0u, 0u, 0u, 0u};
    bf16x8 WR[4], WI[4];
    {
        const bf16* wr = wsp<bf16>(F, WS_WRI) + (size_t)((l * 2 + 0) * 8 + h) * 16384 + (16 * w + c16) * 128 + 8 * q;
        const bf16* wi = wsp<bf16>(F, WS_WRI) + (size_t)((l * 2 + 1) * 8 + h) * 16384 + (16 * w + c16) * 128 + 8 * q;
#pragma unroll
        for (int kb = 0; kb < 4; ++kb) { WR[kb] = *(const bf16x8*)(wr + 32 * kb); WI[kb] = *(const bf16x8*)(wi + 32 * kb); }
    }
    const int cj = l * 1024 + h * 128 + 16 * w + c16;
    const float brj = pin(F, P_B_R)[cj], bij = pin(F, P_B_I)[cj], spj = (wsp<float>(F, WS_SML) + DEPTH * 1024)[cj];
    float hcar = 0.f;
    const size_t tok0 = (size_t)bl * SEQ;
    const bf16* zx = wsp<bf16>(F, WS_Z) + (tok0 + row) * NCOL + C_LX + h * 128 + colp;
    bf16* yo = wsp<bf16>(F, WS_YA) + (size_t)1 * MG * DM + (tok0 + row) * DM + h * 128 + colp;
    constexpr int NCH = SEQ / 32;
    auto ld = [&](int c) { LrLoad r; const bf16* p = zx + (size_t)c * 32 * NCOL; r.x = *(const v4u*)p; r.g = *(const v4u*)(p + 1024); return r; };
    __syncthreads();
    auto prep = [&](const LrLoad& R, int par) {
        *(LAS v4u*)(L + XRAW + (3 + row) * SX + colp * 2) = R.x;
        asm volatile("s_waitcnt lgkmcnt(0)" ::: "memory");
        float xb[8];
        { const f32x4 b0 = *(const LAS f32x4*)(L + CWO + 4 * 512 + colp * 4), b1 = *(const LAS f32x4*)(L + CWO + 4 * 512 + colp * 4 + 16);
#pragma unroll
          for (int e = 0; e < 4; ++e) { xb[e] = b0[e]; xb[4 + e] = b1[e]; } }
#pragma unroll
        for (int j = 0; j < 4; ++j) {
            const v4u t = *(const LAS v4u*)(L + XRAW + (row + j) * SX + colp * 2);
            const f32x4 w0 = *(const LAS f32x4*)(L + CWO + j * 512 + colp * 4), w1 = *(const LAS f32x4*)(L + CWO + j * 512 + colp * 4 + 16);
            float xv[8]; unpack8(t, xv);
#pragma unroll
            for (int e = 0; e < 4; ++e) { xb[e] += w0[e] * xv[e]; xb[4 + e] += w1[e] * xv[4 + e]; }
        }
        asm volatile("s_waitcnt lgkmcnt(0)" ::: "memory");
        if (row >= 29) *(LAS v4u*)(L + XRAW + (row - 29) * SX + colp * 2) = R.x;
        *(LAS v4u*)(L + IMG_XB + par * 32 * SX + row * SX + colp * 2) = pack8(xb);
    };
    LrLoad R1 = ld(0), R2 = ld(1);
    prep(R1, 0);
    v4u gate_cur = R1.g, gate_nxt = R2.g;
    R1 = R2;
    __syncthreads();
    for (int c = 0; c < NCH; ++c) {
        const int par = c & 1;
        if (c + 2 < NCH) R2 = ld(c + 2);
        const LAS unsigned char* I = L + IMG_XB + par * 32 * SX;
        f32x4 Rr[2], Ii[2];
#pragma unroll
        for (int tt = 0; tt < 2; ++tt) { Rr[tt] = (f32x4){0.f, 0.f, 0.f, 0.f}; Ii[tt] = Rr[tt];
#pragma unroll
            for (int kb = 0; kb < 4; ++kb) { const bf16x8 XF = *(const LAS bf16x8*)(I + (16 * tt + c16) * SX + (32 * kb + 8 * q) * 2);
                Rr[tt] = mfma16(XF, WR[kb], Rr[tt]); Ii[tt] = mfma16(XF, WI[kb], Ii[tt]); } }
        float av[2][4], bx[2][4];
#pragma unroll
        for (int tt = 0; tt < 2; ++tt)
#pragma unroll
            for (int i = 0; i < 4; ++i) {
                const float xbv = __uint_as_float((unsigned)(*(const LAS unsigned short*)(I + (16 * tt + 4 * q + i) * SX + (16 * w + c16) * 2)) << 16);
                const float r = sigm(Rr[tt][i] + brj), ig = sigm(Ii[tt][i] + bij);
                const float la = -spj * r; const float a = fexp(la); const float x2 = 2.0f * la;
                const float om = -x2 * (1.0f + x2 * (0.5f + x2 * (0.16666667f + x2 * (0.041666668f + x2 * 0.0083333338f))));
                av[tt][i] = a; bx[tt][i] = __builtin_amdgcn_sqrtf(fmaxf(om, 0.f)) * ig * xbv;
            }
        float ho[2][4];
#pragma unroll
        for (int tt = 0; tt < 2; ++tt) {
            float A = av[tt][0], B = bx[tt][0];
#pragma unroll
            for (int i = 1; i < 4; ++i) { B = av[tt][i] * B + bx[tt][i]; A *= av[tt][i]; }
            float hin = hcar, myh = 0.f;
#pragma unroll
            for (int qq = 0; qq < 4; ++qq) { const float Aq = __shfl(A, c16 + 16 * qq), Bq = __shfl(B, c16 + 16 * qq); if (qq == q) myh = hin; hin = Aq * hin + Bq; }
            hcar = hin;
            float hh = myh;
#pragma unroll
            for (int i = 0; i < 4; ++i) { hh = av[tt][i] * hh + bx[tt][i]; ho[tt][i] = hh; }
        }
        LAS unsigned char* HB = L + HBUF + w * HBW;
#pragma unroll
        for (int i = 0; i < 4; ++i) { *(LAS float*)(HB + (4 * q + i) * 80 + c16 * 4) = ho[0][i]; *(LAS float*)(HB + (16 + 4 * q + i) * 80 + c16 * 4) = ho[1][i]; }
        asm volatile("s_waitcnt lgkmcnt(0)" ::: "memory");
        {
            const f32x4 ha = *(const LAS f32x4*)(HB + row * 80 + ch * 32), hb = *(const LAS f32x4*)(HB + row * 80 + ch * 32 + 16);
            float gt[8], ov[8]; unpack8(gate_cur, gt);
#pragma unroll
            for (int e = 0; e < 4; ++e) { ov[e] = ha[e] * silu(gt[e]); ov[4 + e] = hb[e] * silu(gt[4 + e]); }
            *(v4u*)(yo + (size_t)c * 32 * DM) = pack8(ov);
        }
        asm volatile("s_waitcnt lgkmcnt(0)" ::: "memory");
        if (c + 1 < NCH) { prep(R1, par ^ 1); gate_nxt = R1.g; }
        __syncthreads();
        gate_cur = gate_nxt; R1 = R2;
    }
}

namespace gm {
constexpr int STATS = 0, VH = 1024, VHW = 128 * 32, MB = VH + 8 * VHW, MBW = 128 * 80, LDS_END = MB + 8 * MBW;
static_assert(LDS_END <= RING_BYTES && (MB % 16) == 0, "gmlp lds map");
}
DI void mix_gmlp(const Frame& F0, int l, int bl, int n) {
    const Frame F = phase_frame(F0);
    using namespace gm;
    LAS unsigned char* L = F.lds;
    const int w = F.wave, ln = F.lane, row = ln & 31, ch = ln >> 5, q = ln >> 4, c16 = ln & 15, ta = c16 >> 2, tp = c16 & 3;
    const size_t tok0 = (size_t)bl * SEQ + 128 * n;
    const bf16* zb = wsp<bf16>(F, WS_Z) + tok0 * NCOL;
#pragma unroll 2
    for (int i = 0; i < 16; ++i) {
        const int r = 16 * w + i;
        const bf16* zr = zb + (size_t)r * NCOL + C_V + 8 * ln;
        const v4u r0 = *(const v4u*)zr, r1 = *(const v4u*)(zr + 512);
        float a[8], b[8]; unpack8(r0, a); unpack8(r1, b);
        float s = 0.f, ss = 0.f;
#pragma unroll
        for (int e = 0; e < 8; ++e) { const float g0 = gelu_t(a[e]), g1 = gelu_t(b[e]); s += g0 + g1; ss += g0 * g0 + g1 * g1; }
        s = wave_sum(s); ss = wave_sum(ss);
        const float mean = s * (1.0f / 1024.0f); const float var = fmaxf(ss * (1.0f / 1024.0f) - mean * mean, 0.f);
        if (ln == 0) { ((LAS float*)(L + STATS))[2 * r] = mean; ((LAS float*)(L + STATS))[2 * r + 1] = frsq(var + EPSN); }
    }
    __syncthreads();
    LAS unsigned char* VHw = L + VH + w * VHW;
    LAS unsigned char* MBw = L + MB + w * MBW;
    bf16* ya = wsp<bf16>(F, WS_YA) + tok0 * DM;
    for (int g = 0; g < 8; ++g) {
        const int colp = 128 * g + 16 * w + 8 * ch;
        float lg[8], lbb[8];
#pragma unroll
        for (int e = 0; e < 8; ++e) { lg[e] = pin(F, P_LN_G)[l * 1024 + colp + e]; lbb[e] = pin(F, P_LN_B)[l * 1024 + colp + e]; }
#pragma unroll
        for (int rb = 0; rb < 4; ++rb) {
            const int rr = 32 * rb + row;
            const v4u rv = *(const v4u*)(zb + (size_t)rr * NCOL + C_V + colp);
            const float mean = ((const LAS float*)(L + STATS))[2 * rr], rstd = ((const LAS float*)(L + STATS))[2 * rr + 1];
            float v[8]; unpack8(rv, v);
#pragma unroll
            for (int e = 0; e < 8; ++e) v[e] = (gelu_t(v[e]) - mean) * rstd * lg[e] + lbb[e];
            *(LAS v4u*)(VHw + rr * 32 + ch * 16) = pack8(v);
        }
        asm volatile("s_waitcnt lgkmcnt(0)" ::: "memory");
        bf16x8 VB[4];
#pragma unroll
        for (int kb = 0; kb < 4; ++kb) VB[kb] = cat4(tr16(VHw + (32 * kb + 8 * q + ta) * 32 + tp * 8), tr16(VHw + (32 * kb + 8 * q + 4 + ta) * 32 + tp * 8));
        const bf16* wm = wsp<bf16>(F, WS_WSM) + (size_t)(l * 8 + g) * 16384 + c16 * 128 + 8 * q;
        const float* bs = pin(F, P_B_S) + (size_t)(l * 8 + g) * 128 + 4 * q;
        f32x4 mx[8];
#pragma unroll
        for (int ti = 0; ti < 8; ++ti) {
            mx[ti] = *(const f32x4*)(bs + 16 * ti);
#pragma unroll
            for (int kb = 0; kb < 4; ++kb) if (2 * kb <= ti) { const bf16x8 WF = *(const bf16x8*)(wm + (size_t)(16 * ti) * 128 + 32 * kb); mx[ti] = mfma16(WF, VB[kb], mx[ti]); }
        }
#pragma unroll
        for (int ti = 0; ti < 8; ++ti)
#pragma unroll
            for (int i = 0; i < 4; ++i) *(LAS float*)(MBw + (16 * ti + 4 * q + i) * 80 + c16 * 4) = mx[ti][i];
        asm volatile("s_waitcnt lgkmcnt(0)" ::: "memory");
#pragma unroll
        for (int rb = 0; rb < 4; ++rb) {
            const int rr = 32 * rb + row;
            const v4u ru = *(const v4u*)(zb + (size_t)rr * NCOL + C_U + colp), rg = *(const v4u*)(zb + (size_t)rr * NCOL + C_GA + colp);
            const f32x4 ma = *(const LAS f32x4*)(MBw + rr * 80 + ch * 32), mb = *(const LAS f32x4*)(MBw + rr * 80 + ch * 32 + 16);
            float u[8], gt[8], ov[8]; unpack8(ru, u); unpack8(rg, gt);
#pragma unroll
            for (int e = 0; e < 4; ++e) { ov[e] = gelu_t(u[e]) * ma[e] * silu(gt[e]); ov[4 + e] = gelu_t(u[4 + e]) * mb[e] * silu(gt[4 + e]); }
            *(v4u*)(ya + (size_t)rr * DM + colp) = pack8(ov);
        }
        asm volatile("s_waitcnt lgkmcnt(0)" ::: "memory");
    }
    __syncthreads();
}

DI void zero_block(const Frame& F0, bf16* base, size_t row0, int nrows, int col0, int ncols) {
    const Frame F = phase_frame(F0);
    const int cpr = ncols / 8;
    for (int i = F.tid; i < nrows * cpr; i += NWAVES * 64) { const int r = i / cpr, c = i % cpr; *(v4u*)(base + (row0 + r) * DM + col0 + 8 * c) = (v4u){0u, 0u, 0u, 0u}; }
}
struct Args { const float* in[22]; float* out; unsigned char* ws; int single, do_p0, g_lo, g_hi, l_lo, l_hi, ph_lo, ph_hi; };
__global__ void __launch_bounds__(NWAVES * 64, 2) fwd(Args args) {
    extern __shared__ __attribute__((aligned(16))) unsigned char lds[];
    Frame F;
    F.lds = (LAS unsigned char*)lds;
    F.MISC = (volatile LAS unsigned*)(F.lds + MISC_OFF);
    F.tid = threadIdx.x; F.lane = F.tid & 63; F.wave = __builtin_amdgcn_readfirstlane(F.tid >> 6);
    F.G = gridDim.x; { const int bx = blockIdx.x; F.vcu = (F.G % 8 == 0) ? (bx % 8) * (F.G / 8) + bx / 8 : bx; }
    F.ctl = (gu32*)(args.ws + WS_CTL);
    for (int u = F.tid; u < (LDS_BYTES - LDSCTL_OFF) / 4; u += NWAVES * 64) ((LAS unsigned*)(F.lds + LDSCTL_OFF))[u] = 0u;
    __syncthreads();
    if (F.tid < P_N) { const unsigned long long pv = F.tid < 22 ? (unsigned long long)args.in[F.tid < 22 ? F.tid : 0] : F.tid == P_OUT ? (unsigned long long)args.out : (unsigned long long)args.ws;
        ((LAS unsigned long long*)(F.lds + LDSCTL_OFF))[F.tid] = pv; }
    __syncthreads();
    const bool single = args.single != 0;
    XcdBarrier bar; bar.bar = (unsigned*)(F.ctl + CW_BAR); bar.x = 0; bar.st = nullptr;
    if (single) bar = xcd_barrier_post((unsigned*)(F.ctl + CW_BAR), F.MISC + 8);
#define GRID_BAR() do { if (single) xcd_barrier(bar); } while (0)
    const int lo = args.ph_lo, hi = args.ph_hi;
#ifndef PHM
#define PHM 0xff
#endif
#ifndef MXM
#define MXM 7
#endif
#define IN(k) (((PHM >> (k)) & 1) && lo <= (k) && (k) < hi)

    if (((PHM >> 7) & 1) && args.do_p0) { p0_prologue(F); GRID_BAR(); }

    for (int grp = args.g_lo; grp < args.g_hi; ++grp) {
        for (int l = args.l_lo; l < args.l_hi; ++l) {
            if (IN(0)) { norm_phase(F, l, grp); GRID_BAR(); }
            if (l == DEPTH) continue;
            if (IN(1)) {
                pg8::Gemm g{wsp<bf16>(F, WS_XN), wsp<bf16>(F, WS_WIN) + (size_t)l * NCOL * DM, MG, NCOL, DM}; pg8::StaticOrder S; S.init(MG, NCOL, F.G, (int)blockIdx.x);
                pg8::EpiZ E{wsp<bf16>(F, WS_Z), NCOL};
                pg8::gemm_phase<pg8::EpiZ, pg8::StaticOrder, true, true>(F.lds, g, S, E);
                GRID_BAR();
            }
            if (IN(2)) {
                const int it = (int)blockIdx.x;
                if (F.G == 256) {
                    if (it < 64) { if (MXM & 1) mix_hgrn(F, l, it >> 3, it & 7); else zero_block(F, wsp<bf16>(F, WS_YA) + (size_t)2 * MG * DM, (size_t)(it >> 3) * SEQ, SEQ, (it & 7) * 128, 128); }
                    else if (it < 128) { if (MXM & 2) mix_lru(F, l, (it - 64) >> 3, (it - 64) & 7); else zero_block(F, wsp<bf16>(F, WS_YA) + (size_t)1 * MG * DM, (size_t)((it - 64) >> 3) * SEQ, SEQ, ((it - 64) & 7) * 128, 128); }
                    else { if (MXM & 4) mix_gmlp(F, l, (it - 128) >> 4, (it - 128) & 15); else zero_block(F, wsp<bf16>(F, WS_YA), (size_t)((it - 128) >> 4) * SEQ + 128 * ((it - 128) & 15), 128, 0, 1024); }
                }
                GRID_BAR();
            }
            if (IN(3)) {
                pg8::Gemm g{wsp<bf16>(F, WS_YA), wsp<bf16>(F, WS_WPJ) + (size_t)(l * 4) * DM * DM, 3 * MG, 3 * DM, DM}; pg8::ProjOrder S; S.so.init(MG, DM, F.G, (int)blockIdx.x);
                pg8::EpiMerge E{wsp<bf16>(F, WS_Z) + C_MG, pin(F, P_B_MERGE) + (size_t)l * 3 * DM, wsp<float>(F, WS_PART), wsp<bf16>(F, WS_MRG)};
                pg8::gemm_phase<pg8::EpiMerge, pg8::ProjOrder, false, true>(F.lds, g, S, E);
                GRID_BAR();
            }
            if (IN(4)) {
                pg8::Gemm g{wsp<bf16>(F, WS_MRG), wsp<bf16>(F, WS_WPJ) + (size_t)(l * 4 + 3) * DM * DM, MG, DM, DM}; pg8::StaticOrder S; S.init(MG, DM, F.G, (int)blockIdx.x);
                pg8::EpiY E{wsp<float>(F, WS_Y), DM};
                pg8::gemm_phase<pg8::EpiY, pg8::StaticOrder, false, true>(F.lds, g, S, E);
                GRID_BAR();
            }
        }
    }
#undef IN
#undef GRID_BAR
}

#ifndef MK_SINGLE
#define MK_SINGLE 0
#endif
extern "C" void kernel_launch(void* const* d_in, const int* in_sizes, int n_in, void* d_out, int out_size, void* d_ws, size_t ws_size, hipStream_t stream) {
    static int grid = 0;
    if (grid == 0) {
        if (n_in != 22 || out_size != BATCH * SEQ * DM || ws_size < WS_END) { fprintf(stderr, "kernel_launch: unexpected shapes (n_in %d, out %d, ws %zu, need %zu)\n", n_in, out_size, ws_size, (size_t)WS_END); grid = -1; return; }
        int dev = 0, cus = 0;
        if (hipGetDevice(&dev) != hipSuccess || hipDeviceGetAttribute(&cus, hipDeviceAttributeMultiprocessorCount, dev) != hipSuccess) { grid = -1; return; }
        if (hipFuncSetAttribute((const void*)fwd, hipFuncAttributeMaxDynamicSharedMemorySize, LDS_BYTES) != hipSuccess) { fprintf(stderr, "kernel_launch: hipFuncSetAttribute failed\n"); grid = -1; return; }
        int per_cu = 0;
        if (hipOccupancyMaxActiveBlocksPerMultiprocessor(&per_cu, (const void*)fwd, NWAVES * 64, LDS_BYTES) != hipSuccess || per_cu < 1) { fprintf(stderr, "kernel_launch: occupancy query says %d\n", per_cu); }
        (void)hipGetLastError();
        grid = cus;
        if (grid != 256) fprintf(stderr, "kernel_launch: %d CUs; this kernel expects 256\n", grid);
    }
    if (grid < 0) return;
    (void)hipMemsetAsync((char*)d_ws + WS_CTL, 0, CTL_ZERO_BYTES, stream);
    Args a{};
    for (int i = 0; i < 22; ++i) a.in[i] = (const float*)d_in[i];
    a.out = (float*)d_out; a.ws = (unsigned char*)d_ws;
#if MK_SINGLE
    a.single = 1; a.do_p0 = 1; a.g_lo = 0; a.g_hi = NGRP; a.l_lo = 0; a.l_hi = DEPTH + 1; a.ph_lo = 0; a.ph_hi = 5;
    hipLaunchKernelGGL(fwd, dim3(grid), dim3(NWAVES * 64), LDS_BYTES, stream, a);
#else
    a.single = 0; a.do_p0 = 1; a.g_lo = 0; a.g_hi = 0; a.l_lo = 0; a.l_hi = 0; a.ph_lo = 0; a.ph_hi = 0;
    hipLaunchKernelGGL(fwd, dim3(grid), dim3(NWAVES * 64), LDS_BYTES, stream, a);
    a.do_p0 = 0;
    for (int grp = 0; grp < NGRP; ++grp)
        for (int l = 0; l <= DEPTH; ++l)
            for (int ph = 0; ph < (l == DEPTH ? 1 : 5); ++ph) {
                a.g_lo = grp; a.g_hi = grp + 1; a.l_lo = l; a.l_hi = l + 1; a.ph_lo = ph; a.ph_hi = ph + 1;
                hipLaunchKernelGGL(fwd, dim3(grid), dim3(NWAVES * 64), LDS_BYTES, stream, a);
            }
#endif
}
```
